# Optimizing an MI355X kernel written in HIP

```python
import math
import jax, jax.numpy as jnp
from jax import lax
import numpy as np

D_MODEL = 1024
BATCH = 1
SEQ = 16384
DEPTH = 1

N_MEM = 256
D_MIX = D_MODEL
D_A = D_MIX // 2
D_B = D_MIX - D_A
CONV_A_W = 3
CONV_B_W = 31
D_IN_ALL = 3 * D_A + 2 * D_B
XA_HEADS = 4
XA_HEAD_DIM = D_MODEL // XA_HEADS
D_FF = int(math.ceil((8 * D_MODEL / 3) / 256) * 256)
RMS_EPS = 1e-6
LN_EPS = 1e-5

kernel_name = "hybrid_parallel_conv_groups_xattn_swiglu"


def rmsnorm(x, g):
    xf = x.astype(jnp.float32)
    y = xf * lax.rsqrt(jnp.mean(xf * xf, axis=-1, keepdims=True) + RMS_EPS)
    return (y * g.astype(jnp.float32)).astype(x.dtype)


def layernorm(x, g, b):
    xf = x.astype(jnp.float32)
    mu = jnp.mean(xf, axis=-1, keepdims=True)
    var = jnp.mean(jnp.square(xf - mu), axis=-1, keepdims=True)
    y = (xf - mu) * lax.rsqrt(var + LN_EPS)
    return (y * g.astype(jnp.float32) + b.astype(jnp.float32)).astype(x.dtype)


def causal_dwconv(u, w):
    k = w.shape[0]
    return lax.conv_general_dilated(
        u, w[:, None, :].astype(u.dtype),
        window_strides=(1,), padding=((k - 1, 0),),
        dimension_numbers=("NWC", "WIO", "NWC"),
        feature_group_count=u.shape[-1])


def setup_inputs(seed: int = 0) -> dict:
    key = jax.random.key(seed)
    ks = jax.random.split(key, 24)
    f32 = jnp.float32

    def w(k, shape, fan_in):
        return jax.random.normal(k, shape, f32) * (fan_in ** -0.5)

    def gain(k, n):
        return jnp.ones((n,), f32) + 0.05 * jax.random.normal(k, (n,), f32)

    return {
        "x": jax.random.normal(ks[0], (BATCH, SEQ, D_MODEL), f32),
        "mem": jax.random.normal(ks[1], (BATCH, N_MEM, D_MODEL), f32),
        "mix_pre_g": gain(ks[2], D_MODEL),
        "w_mix_in": w(ks[3], (D_MODEL, D_IN_ALL), D_MODEL),
        "conv_a_w": w(ks[4], (CONV_A_W, D_A), CONV_A_W),
        "conv_b_w": w(ks[5], (CONV_B_W, D_B), CONV_B_W),
        "conv_b_b": 0.02 * jax.random.normal(ks[6], (D_B,), f32),
        "ln_b_g": gain(ks[7], D_B),
        "ln_b_b": 0.02 * jax.random.normal(ks[8], (D_B,), f32),
        "w_mix_out": w(ks[9], (D_MIX, D_MODEL), D_MIX),
        "mix_post_g": gain(ks[10], D_MODEL),
        "xa_pre_g": gain(ks[11], D_MODEL),
        "mem_norm_g": gain(ks[12], D_MODEL),
        "w_q": w(ks[13], (D_MODEL, XA_HEADS * XA_HEAD_DIM), D_MODEL),
        "w_k": w(ks[14], (D_MODEL, XA_HEADS * XA_HEAD_DIM), D_MODEL),
        "w_v": w(ks[15], (D_MODEL, XA_HEADS * XA_HEAD_DIM), D_MODEL),
        "w_o": w(ks[16], (XA_HEADS * XA_HEAD_DIM, D_MODEL), XA_HEADS * XA_HEAD_DIM),
        "xa_post_g": gain(ks[17], D_MODEL),
        "ffn_pre_g": gain(ks[18], D_MODEL),
        "w_gate": w(ks[19], (D_MODEL, D_FF), D_MODEL),
        "w_up": w(ks[20], (D_MODEL, D_FF), D_MODEL),
        "w_down": w(ks[21], (D_FF, D_MODEL), D_FF),
        "ffn_post_g": gain(ks[22], D_MODEL),
    }


def parallel_conv_mixer(h, w_mix_in, conv_a_w, conv_b_w, conv_b_b, ln_b_g, ln_b_b, w_mix_out):
    u = jnp.einsum("bsd,dc->bsc", h, w_mix_in.astype(h.dtype))
    b_a, c_a, v_a, glu_v, glu_g = jnp.split(
        u, [D_A, 2 * D_A, 3 * D_A, 3 * D_A + D_B], axis=-1)
    y_a = b_a * causal_dwconv(c_a * v_a, conv_a_w)
    z = glu_v * jax.nn.sigmoid(glu_g)
    z = causal_dwconv(z, conv_b_w) + conv_b_b.astype(z.dtype)
    y_b = jax.nn.silu(layernorm(z, ln_b_g, ln_b_b))
    y = jnp.concatenate([y_a, y_b], axis=-1)
    return jnp.einsum("bsc,cd->bsd", y, w_mix_out.astype(y.dtype))


def memory_cross_attention(h, mem_n, w_q, w_k, w_v, w_o):
    bsz, s, _ = h.shape
    m = mem_n.shape[1]
    q = jnp.einsum("bsd,de->bse", h, w_q.astype(h.dtype)).reshape(bsz, s, XA_HEADS, XA_HEAD_DIM)
    k = jnp.einsum("bmd,de->bme", mem_n, w_k.astype(h.dtype)).reshape(bsz, m, XA_HEADS, XA_HEAD_DIM)
    v = jnp.einsum("bmd,de->bme", mem_n, w_v.astype(h.dtype)).reshape(bsz, m, XA_HEADS, XA_HEAD_DIM)
    scores = jnp.einsum("bshd,bmhd->bhsm", q.astype(jnp.float32), k.astype(jnp.float32))
    p = jax.nn.softmax(scores * (XA_HEAD_DIM ** -0.5), axis=-1).astype(h.dtype)
    o = jnp.einsum("bhsm,bmhd->bshd", p, v).reshape(bsz, s, XA_HEADS * XA_HEAD_DIM)
    return jnp.einsum("bse,ed->bsd", o, w_o.astype(h.dtype))


def swiglu_ffn(h, w_gate, w_up, w_down):
    g = jnp.einsum("bsd,df->bsf", h, w_gate.astype(h.dtype))
    u = jnp.einsum("bsd,df->bsf", h, w_up.astype(h.dtype))
    return jnp.einsum("bsf,fd->bsd", jax.nn.silu(g) * u, w_down.astype(h.dtype))


def reference(x, mem, mix_pre_g, w_mix_in, conv_a_w, conv_b_w, conv_b_b, ln_b_g, ln_b_b,
              w_mix_out, mix_post_g, xa_pre_g, mem_norm_g, w_q, w_k, w_v, w_o, xa_post_g,
              ffn_pre_g, w_gate, w_up, w_down, ffn_post_g):
    mem_n = rmsnorm(mem, mem_norm_g)
    for _ in range(DEPTH):
        x = x + rmsnorm(parallel_conv_mixer(rmsnorm(x, mix_pre_g), w_mix_in, conv_a_w,
                                            conv_b_w, conv_b_b, ln_b_g, ln_b_b, w_mix_out),
                        mix_post_g)
        x = x + rmsnorm(memory_cross_attention(rmsnorm(x, xa_pre_g), mem_n, w_q, w_k, w_v, w_o),
                        xa_post_g)
        x = x + rmsnorm(swiglu_ffn(rmsnorm(x, ffn_pre_g), w_gate, w_up, w_down), ffn_post_g)
    return x
```

```cpp
#include <hip/hip_runtime.h>
#include <cstdio>
#include <cstdint>

#ifndef OPT_MASK
#define OPT_MASK 0x000
#endif
#ifndef ONE_LAUNCH
#define ONE_LAUNCH 1
#endif

#define LAS __attribute__((address_space(3)))
#define GAS __attribute__((address_space(1)))
typedef unsigned short bf16_t;
typedef short bf16x8 __attribute__((ext_vector_type(8)));
typedef float f32x4 __attribute__((ext_vector_type(4)));
typedef float f32x2 __attribute__((ext_vector_type(2)));
typedef float f32x16 __attribute__((ext_vector_type(16)));
typedef unsigned u32x4 __attribute__((ext_vector_type(4)));
typedef unsigned u32x2 __attribute__((ext_vector_type(2)));

constexpr int M = 16384, D = 1024, NU = 2560, UW = 1536, DA = 512, FF = 2816, NGU = 2 * FF, NMEM = 256, NH = 4, HD = 256;
constexpr float RMS_EPS = 1e-6f, LN_EPS = 1e-5f;
constexpr float QSCALE = 0.0625f * 1.4426950408889634f;

constexpr size_t MiB = 1u << 20;
constexpr size_t WS_CTL = 0, CTL_ZERO_BYTES = 1 * MiB;
constexpr size_t WS_X = 1 * MiB;
constexpr size_t XSLOT_BYTES = (size_t)M * 4 * 4;
constexpr size_t WS_W1 = 4 * MiB, WS_WOUT = 9 * MiB, WS_WQ = 11 * MiB, WS_WK = 13 * MiB, WS_MEMNP = 15 * MiB, WS_MEMN = WS_MEMNP + MiB / 2, WS_WV = 16 * MiB,
                 WS_WO = 18 * MiB, WS_WGU = 20 * MiB, WS_WD = 31 * MiB;
constexpr size_t WS_KM = 37 * MiB, WS_VT = WS_KM + MiB / 2;
constexpr size_t WS_XN = 40 * MiB, WS_U = 72 * MiB, WS_Y = 120 * MiB, WS_QO = 72 * MiB, WS_ACT = 72 * MiB, WS_C = 160 * MiB, WS_END = 224 * MiB;
static_assert(WS_WD + (size_t)D * FF * 2 <= WS_KM && WS_ACT + (size_t)M * FF * 2 <= WS_C && WS_U + (size_t)M * UW * 2 <= WS_Y, "ws map");
constexpr int CW_TMO = 0, CW_CODE = 1, CW_BAR = 4096, CW_SEAM = 40960, SEAM_BANK = 64 * 64;
static_assert((CW_SEAM + 5 * SEAM_BANK) * 4 <= (int)CTL_ZERO_BYTES && CW_BAR + 9 * 3456 <= CW_SEAM, "ctl");

__device__ __forceinline__ unsigned f2bf(float f) { unsigned u = __builtin_bit_cast(unsigned, f); return (u + 0x7fffu + ((u >> 16) & 1u)) >> 16; }
__device__ __forceinline__ unsigned pk2(float lo, float hi) { return f2bf(lo) | (f2bf(hi) << 16); }
__device__ __forceinline__ float bf2f(unsigned short b) { return __builtin_bit_cast(float, (unsigned)b << 16); }
__device__ __forceinline__ float bflo(unsigned w) { return __builtin_bit_cast(float, w << 16); }
__device__ __forceinline__ float bfhi(unsigned w) { return __builtin_bit_cast(float, w & 0xffff0000u); }
__device__ __forceinline__ float sigmoidf_(float x) { return __builtin_amdgcn_rcpf(1.0f + __builtin_amdgcn_exp2f(-1.4426950408889634f * x)); }
__host__ __device__ __forceinline__ int w1_src_col(int np) {
    if (np < 512) return np;
    const int g = (np - 512) >> 8, i = (np - 512) & 255;
    if (g < 4) return i < 128 ? 512 + 128 * g + i : 1024 + 128 * g + (i - 128);
    return i < 128 ? 1536 + 128 * (g - 4) + i : 2048 + 128 * (g - 4) + (i - 128);
}
__host__ __device__ __forceinline__ int vkey_of_pos(int p) { const int q = p & 15, b = p & ~15; return b + ((q < 4 || q >= 12) ? q : (q < 8 ? q + 4 : q - 4)); }

__global__ void __launch_bounds__(256) nk_prep_w(const float* W, const float* W2, const float* g, float scale, bf16_t* WT, int K, int Nsrc, int Ndst, int mode) {
    const size_t idx = (size_t)blockIdx.x * 256 + threadIdx.x; if (idx >= (size_t)Ndst * K) return;
    const int np = (int)(idx / K), k = (int)(idx % K);
    const float* src = W; int col = np;
    if (mode == 1) col = w1_src_col(np);
    else if (mode == 2) { const int gg = np >> 8, i = np & 255; if (i < 128) { col = 128 * gg + i; } else { src = W2; col = 128 * gg + i - 128; } }
    float v = src[(size_t)k * Nsrc + col] * scale; if (g) v *= g[k];
    WT[idx] = (bf16_t)f2bf(v);
}
__device__ __forceinline__ float block_sum_256(float v, float* sh) {
    for (int o = 1; o < 64; o <<= 1) v += __shfl_xor(v, o);
    __syncthreads(); if ((threadIdx.x & 63) == 0) sh[threadIdx.x >> 6] = v; __syncthreads();
    float t = 0.f; for (int i = 0; i < (int)(blockDim.x >> 6); ++i) t += sh[i]; return t;
}
__global__ void __launch_bounds__(256) nk_rmsrow(const float* x, const float* g, bf16_t* o, bf16_t* o2, int permute) {
    __shared__ float sh[8]; const int row = blockIdx.x; const float* xr = x + (size_t)row * D;
    float v[4], s = 0.f; for (int j = 0; j < 4; ++j) { v[j] = xr[threadIdx.x + 256 * j]; s += v[j] * v[j]; }
    const float rstd = 1.0f / sqrtf(block_sum_256(s, sh) / D + RMS_EPS);
    for (int j = 0; j < 4; ++j) { const int c = threadIdx.x + 256 * j; const float y = v[j] * rstd * (g ? g[c] : 1.f); o[(size_t)row * D + c] = (bf16_t)f2bf(y);
        if (permute) { int p = 0; for (int q = 0; q < NMEM; ++q) if (vkey_of_pos(q) == row) p = q; o2[(size_t)p * D + c] = (bf16_t)f2bf(y); } }
}
struct NEpiF32 { static constexpr int NT = 1; float* C; int ldc, pad; __device__ void operator()(int row, int n0, int l31, float v0, float) const { C[(size_t)row * ldc + n0 + l31] = v0; } };
struct NEpiBf16 { static constexpr int NT = 1; bf16_t* O; int ldc, pad; __device__ void operator()(int row, int n0, int l31, float v0, float) const { O[(size_t)row * ldc + n0 + l31] = (bf16_t)f2bf(v0); } };
struct NEpiPair { static constexpr int NT = 2; bf16_t* O; int ldc, col_off, gsplit, mode;
    __device__ void operator()(int row, int n0, int l31, float v0, float v1) const { const int g = n0 >> 8, s = (n0 & 255) >> 5; float r;
        if (g < gsplit) r = v0 * v1; else if (mode == 1) r = v0 * sigmoidf_(v1); else r = v0 * sigmoidf_(v0) * v1;
        O[(size_t)row * ldc + col_off + 128 * g + 32 * s + l31] = (bf16_t)f2bf(r); } };
template <class Epi> __global__ void __launch_bounds__(256) nk_gemm(const bf16_t* A, const bf16_t* Bt, int Mr, int Ncols, int K, Epi epi) {
    const int lane = threadIdx.x & 63, l31 = lane & 31, hi = lane >> 5; const int gw = blockIdx.x * 4 + (threadIdx.x >> 6);
    const int ntn = Epi::NT == 1 ? Ncols / 32 : Ncols / 64; const int tm = gw / ntn, tn = gw % ntn; if (tm >= Mr / 32) return;
    const int n0 = Epi::NT == 1 ? 32 * tn : 256 * (tn >> 2) + 32 * (tn & 3);
    f32x16 a0 = {}, a1 = {};
    const bf16_t* ap = A + (size_t)(tm * 32 + l31) * K + hi * 8; const bf16_t* bp = Bt + (size_t)(n0 + l31) * K + hi * 8;
    for (int k = 0; k < K; k += 16) { const bf16x8 af = *(const bf16x8*)(ap + k); const bf16x8 bf = *(const bf16x8*)(bp + k);
        a0 = __builtin_amdgcn_mfma_f32_32x32x16_bf16(af, bf, a0, 0, 0, 0);
        if (Epi::NT == 2) { const bf16x8 bg = *(const bf16x8*)(bp + (size_t)128 * K + k); a1 = __builtin_amdgcn_mfma_f32_32x32x16_bf16(af, bg, a1, 0, 0, 0); } }
    for (int r = 0; r < 16; ++r) epi(tm * 32 + (r & 3) + 8 * (r >> 2) + 4 * hi, n0, l31, a0[r], a1[r]);
}
__global__ void __launch_bounds__(512) nk_conv(const bf16_t* U, const float* wa, const float* wb, const float* bb, const float* lg, const float* lb, bf16_t* Y) {
    __shared__ float sh[8]; const int t = blockIdx.x, c = threadIdx.x;
    float ca = 0.f; for (int k = 0; k < 3; ++k) { const int tt = t - 2 + k; if (tt >= 0) ca += wa[k * DA + c] * bf2f(U[(size_t)tt * UW + 512 + c]); }
    Y[(size_t)t * D + c] = (bf16_t)f2bf(bf2f(U[(size_t)t * UW + c]) * ca);
    float z = bb[c]; for (int k = 0; k < 31; ++k) { const int tt = t - 30 + k; if (tt >= 0) z += wb[k * DA + c] * bf2f(U[(size_t)tt * UW + 1024 + c]); }
    float s = z; for (int o = 1; o < 64; o <<= 1) s += __shfl_xor(s, o);
    __syncthreads(); if ((c & 63) == 0) sh[c >> 6] = s; __syncthreads(); float mean = 0.f; for (int i = 0; i < 8; ++i) mean += sh[i]; mean /= DA;
    float d = (z - mean) * (z - mean); for (int o = 1; o < 64; o <<= 1) d += __shfl_xor(d, o);
    __syncthreads(); if ((c & 63) == 0) sh[c >> 6] = d; __syncthreads(); float var = 0.f; for (int i = 0; i < 8; ++i) var += sh[i]; var /= DA;
    const float y = (z - mean) / sqrtf(var + LN_EPS) * lg[c] + lb[c];
    Y[(size_t)t * D + 512 + c] = (bf16_t)f2bf(y * sigmoidf_(y));
}
__global__ void __launch_bounds__(256) nk_rownorm(const float* C, const float* base, const float* g, float* out, bf16_t* xn) {
    __shared__ float sh[8]; const int row = blockIdx.x; float v[4], s = 0.f;
    for (int j = 0; j < 4; ++j) { v[j] = C[(size_t)row * D + threadIdx.x + 256 * j]; s += v[j] * v[j]; }
    const float r1 = 1.0f / sqrtf(block_sum_256(s, sh) / D + RMS_EPS); float s2 = 0.f;
    for (int j = 0; j < 4; ++j) { const int c = threadIdx.x + 256 * j; v[j] = base[(size_t)row * D + c] + v[j] * r1 * g[c]; s2 += v[j] * v[j]; out[(size_t)row * D + c] = v[j]; }
    if (xn) { const float r2 = 1.0f / sqrtf(block_sum_256(s2, sh) / D + RMS_EPS); for (int j = 0; j < 4; ++j) xn[(size_t)row * D + threadIdx.x + 256 * j] = (bf16_t)f2bf(v[j] * r2); }
}
__global__ void __launch_bounds__(256) nk_attn(const bf16_t* Q, const bf16_t* Km, const bf16_t* Vt, bf16_t* O) {
    __shared__ float q[HD], p[NMEM], sh[8]; const int row = blockIdx.x >> 2, h = blockIdx.x & 3, t = threadIdx.x;
    q[t] = bf2f(Q[(size_t)row * D + h * HD + t]); __syncthreads();
    float s = 0.f; for (int d = 0; d < HD; ++d) s += q[d] * bf2f(Km[(size_t)t * D + h * HD + d]);
    float mx = s; for (int o = 1; o < 64; o <<= 1) mx = fmaxf(mx, __shfl_xor(mx, o));
    if ((t & 63) == 0) sh[t >> 6] = mx; __syncthreads(); mx = fmaxf(fmaxf(sh[0], sh[1]), fmaxf(sh[2], sh[3]));
    const float e = exp2f(s - mx); p[t] = e; const float l = block_sum_256(e, sh + 4);
    float o = 0.f; for (int pos = 0; pos < NMEM; ++pos) o += p[vkey_of_pos(pos)] * bf2f(Vt[(size_t)(h * HD + t) * NMEM + pos]);
    O[(size_t)row * D + h * HD + t] = (bf16_t)f2bf(o / l);
}

namespace pg8 {
constexpr int BM = 256, BK = 64, HALF = 128, HTB = HALF * BK * 2, STAGE_BYTES = 8 * HTB, NXCD = 8, WGM = 8;
__host__ __device__ __forceinline__ int lds_byte(int r, int c) { const int st = (r >> 4) * 2 + (c >> 5), rr = r & 15, cc = c & 31, ob = rr * 64 + cc * 2; return st * 1024 + (ob ^ (((ob >> 9) & 1) << 5)); }
__host__ __device__ __forceinline__ void stage_rc(int b, int& R, int& C) { const int st = b / 1024, sb = b % 1024, swz = sb ^ (((sb >> 9) & 1) << 5); R = (st >> 1) * 16 + swz / 64; C = (st & 1) * 32 + (swz % 64) / 2; }
__host__ __device__ __forceinline__ int perm32(int rho) { const int n = rho >> 4, i = rho & 15; return 8 * (i >> 2) + 4 * n + (i & 3); }
struct Unit { int pm, pn; };
struct Gemm { const bf16_t* A; const bf16_t* Bt; int M, N, K; };
struct StaticOrder {
    int nM, nN, nwg, G, c;
    __host__ __device__ void init(int M_, int N_, int G_, int c_) { nM = M_ / BM; nN = N_ / BM; nwg = nM * nN; G = G_; c = c_; }
    __host__ __device__ bool next(int i, Unit& u) const {
        const long L = (long)i * G + c; if (L >= nwg) return false;
        int wgid = (int)L; { const int q = nwg / NXCD, r = nwg % NXCD, xcd = wgid % NXCD, off = wgid / NXCD; wgid = (xcd < r ? xcd * (q + 1) : r * (q + 1) + (xcd - r) * q) + off; }
        const int nig = WGM * nN, gid = wgid / nig, fm = gid * WGM, gsz = (nM - fm) < WGM ? (nM - fm) : WGM;
        u.pm = fm + ((wgid % nig) % gsz); u.pn = (wgid % nig) / gsz; return true;
    }
    __device__ __forceinline__ void a_ready(const Unit&) const {}
    __device__ __forceinline__ void done(const Unit&) const {}
};
struct KVOrder {
    int j;
    __device__ bool next(int i, Unit& u) const { if (i != 0 || j < 0 || j >= 8) return false; if (j < 4) { u.pm = 0; u.pn = j; } else { u.pm = j - 3; u.pn = 4; } return true; }
    __device__ __forceinline__ void a_ready(const Unit&) const {}
    __device__ __forceinline__ void done(const Unit&) const {}
};
__device__ __forceinline__ unsigned cvt_pk_bf16(float lo, float hi) { unsigned r; asm volatile("v_cvt_pk_bf16_f32 %0, %1, %2" : "=v"(r) : "v"(lo), "v"(hi)); return r; }
__device__ __forceinline__ u32x4 pack8(const f32x4 a, const f32x4 b) { u32x4 w; w.x = cvt_pk_bf16(a[0], a[1]); w.y = cvt_pk_bf16(a[2], a[3]); w.z = cvt_pk_bf16(b[0], b[1]); w.w = cvt_pk_bf16(b[2], b[3]); return w; }
__device__ __forceinline__ f32x4 sig4(const f32x4 x) { f32x4 r; r[0] = sigmoidf_(x[0]); r[1] = sigmoidf_(x[1]); r[2] = sigmoidf_(x[2]); r[3] = sigmoidf_(x[3]); return r; }

struct EpiBf16P {
    static constexpr bool PERM = true, AFTER_DRAIN = false; bf16_t* O; int ldc;
    __device__ __forceinline__ void operator()(const f32x4 (&acc)[2][2][4][2], const Unit& u, int wr, int wc, int fr, int fq) const {
        const int row0 = u.pm * BM + wr * 64 + fr, col0 = u.pn * BM + wc * 32 + 8 * fq;
#pragma unroll
        for (int ai = 0; ai < 2; ++ai)
#pragma unroll
            for (int m = 0; m < 4; ++m) { bf16_t* rowp = O + (size_t)(row0 + ai * HALF + m * 16) * ldc + col0;
#pragma unroll
                for (int bj = 0; bj < 2; ++bj) *(u32x4*)(rowp + bj * HALF) = pack8(acc[ai][bj][m][0], acc[ai][bj][m][1]); }
    }
};
struct EpiKV {
    static constexpr bool PERM = true, AFTER_DRAIN = false; bf16_t* Km; bf16_t* Vt;
    __device__ __forceinline__ void operator()(const f32x4 (&acc)[2][2][4][2], const Unit& u, int wr, int wc, int fr, int fq) const {
        const bool isk = u.pn < 4; bf16_t* base = isk ? Km + u.pn * BM : Vt + (size_t)(u.pm - 1) * BM * NMEM; const int ldc = isk ? D : NMEM;
        const int row0 = wr * 64 + fr, col0 = wc * 32 + 8 * fq;
#pragma unroll
        for (int ai = 0; ai < 2; ++ai)
#pragma unroll
            for (int m = 0; m < 4; ++m) { bf16_t* rowp = base + (size_t)(row0 + ai * HALF + m * 16) * ldc + col0;
#pragma unroll
                for (int bj = 0; bj < 2; ++bj) *(u32x4*)(rowp + bj * HALF) = pack8(acc[ai][bj][m][0], acc[ai][bj][m][1]); }
    }
};
struct EpiU {
    static constexpr bool PERM = true, AFTER_DRAIN = false; bf16_t* U;
    __device__ __forceinline__ void operator()(const f32x4 (&acc)[2][2][4][2], const Unit& u, int wr, int wc, int fr, int fq) const {
        const int row0 = u.pm * BM + wr * 64 + fr;
        if (u.pn < 2) {
            const int col0 = u.pn * BM + wc * 32 + 8 * fq;
#pragma unroll
            for (int ai = 0; ai < 2; ++ai)
#pragma unroll
                for (int m = 0; m < 4; ++m) { bf16_t* rowp = U + (size_t)(row0 + ai * HALF + m * 16) * UW + col0;
#pragma unroll
                    for (int bj = 0; bj < 2; ++bj) *(u32x4*)(rowp + bj * HALF) = pack8(acc[ai][bj][m][0], acc[ai][bj][m][1]); }
        } else {
            const int g = u.pn - 2, col0 = 512 + 128 * g + wc * 32 + 8 * fq; const bool glu = g >= 4;
#pragma unroll
            for (int ai = 0; ai < 2; ++ai)
#pragma unroll
                for (int m = 0; m < 4; ++m) { bf16_t* rowp = U + (size_t)(row0 + ai * HALF + m * 16) * UW + col0;
                    f32x4 g0 = acc[ai][1][m][0], g1 = acc[ai][1][m][1]; if (glu) { g0 = sig4(g0); g1 = sig4(g1); }
                    *(u32x4*)rowp = pack8(acc[ai][0][m][0] * g0, acc[ai][0][m][1] * g1); }
        }
    }
};
struct EpiSwiGLU {
    static constexpr bool PERM = true, AFTER_DRAIN = false; bf16_t* O;
    __device__ __forceinline__ void operator()(const f32x4 (&acc)[2][2][4][2], const Unit& u, int wr, int wc, int fr, int fq) const {
        const int row0 = u.pm * BM + wr * 64 + fr, col0 = 128 * u.pn + wc * 32 + 8 * fq;
#pragma unroll
        for (int ai = 0; ai < 2; ++ai)
#pragma unroll
            for (int m = 0; m < 4; ++m) { bf16_t* rowp = O + (size_t)(row0 + ai * HALF + m * 16) * FF + col0;
                const f32x4 a0 = acc[ai][0][m][0], a1 = acc[ai][0][m][1];
                *(u32x4*)rowp = pack8(a0 * sig4(a0) * acc[ai][1][m][0], a1 * sig4(a1) * acc[ai][1][m][1]); }
    }
};
struct RmsStats {
    unsigned* xbuf;
    unsigned* cnt;
    unsigned* tmo;
    unsigned code;
    __device__ __forceinline__ bool run(const f32x4 (&v)[2][2][4][2], const Unit& u, int wr, int wc, int fr, int fq, LAS unsigned char* lds, int wid, int lane) const {
        LAS float* P = (LAS float*)lds;
        LAS float* S = (LAS float*)(lds + 4096);
        LAS unsigned* flag = (LAS unsigned*)(lds + 4096 + 1024);
#pragma unroll
        for (int ai = 0; ai < 2; ++ai)
#pragma unroll
            for (int m = 0; m < 4; ++m) { float q = 0.f;
#pragma unroll
                for (int bj = 0; bj < 2; ++bj)
#pragma unroll
                    for (int n = 0; n < 2; ++n) { const f32x4 x = v[ai][bj][m][n]; q += (x[0] * x[0] + x[1] * x[1]) + (x[2] * x[2] + x[3] * x[3]); }
                q += __shfl_xor(q, 16); q += __shfl_xor(q, 32);
                if (fq == 0) P[(ai * HALF + wr * 64 + m * 16 + fr) * 4 + wc] = q; }
        asm volatile("s_waitcnt lgkmcnt(0)" ::: "memory"); __builtin_amdgcn_s_barrier(); asm volatile("" ::: "memory");
        const int row = wid * 32 + (lane & 31);
        if (lane < 32) { const float tot = (P[row * 4 + 0] + P[row * 4 + 1]) + (P[row * 4 + 2] + P[row * 4 + 3]);
            __hip_atomic_store(xbuf + ((size_t)(u.pm * BM + row) * 4 + u.pn), __float_as_uint(tot), __ATOMIC_RELAXED, __HIP_MEMORY_SCOPE_AGENT); }
        asm volatile("s_waitcnt vmcnt(0)" ::: "memory");
        if (lane == 0) __hip_atomic_fetch_add(cnt + 64 * u.pm, 1u, __ATOMIC_RELAXED, __HIP_MEMORY_SCOPE_AGENT);
        if (wid == 0) {
            bool dead = false; const unsigned long long t0 = __builtin_amdgcn_s_memrealtime();
            for (;;) {
                if ((unsigned)__builtin_amdgcn_readfirstlane(__hip_atomic_load(cnt + 64 * u.pm, __ATOMIC_RELAXED, __HIP_MEMORY_SCOPE_AGENT)) >= 32u) break;
                if (__builtin_amdgcn_s_memrealtime() - t0 > 2000000ull) {
                    if (lane == 0) { unsigned expect = 0u; __hip_atomic_compare_exchange_strong(tmo + 1, &expect, code | (unsigned)(u.pm & 0xff), __ATOMIC_RELAXED, __ATOMIC_RELAXED, __HIP_MEMORY_SCOPE_AGENT);
                                     __hip_atomic_store(tmo, 1u, __ATOMIC_RELAXED, __HIP_MEMORY_SCOPE_AGENT); }
                    dead = true; break; }
                __builtin_amdgcn_s_sleep(2);
            }
            __builtin_amdgcn_fence(__ATOMIC_ACQUIRE, "agent");
            if (lane == 0) flag[0] = dead ? 1u : 0u;
        }
        asm volatile("s_waitcnt vmcnt(0) lgkmcnt(0)" ::: "memory"); __builtin_amdgcn_s_barrier(); asm volatile("" ::: "memory");
        const bool bad = flag[0] != 0u;
        if (lane < 32) { const unsigned* slot = xbuf + (size_t)(u.pm * BM + row) * 4; float s = 0.f;
#pragma unroll
            for (int t = 0; t < 4; ++t) s += __uint_as_float(__hip_atomic_load(slot + t, __ATOMIC_RELAXED, __HIP_MEMORY_SCOPE_AGENT));
            S[row] = 1.0f / sqrtf(s * (1.0f / D) + RMS_EPS); }
        asm volatile("s_waitcnt lgkmcnt(0)" ::: "memory"); __builtin_amdgcn_s_barrier(); asm volatile("" ::: "memory");
        return bad;
    }
};
struct EpiRmsRes {
    static constexpr bool PERM = false, AFTER_DRAIN = true;
    const float* base; float* out; const float* gpost; RmsStats st;
    __device__ __forceinline__ void fused(f32x4 (&acc)[2][2][4][2], const Unit& u, int wr, int wc, int fr, int fq, LAS unsigned char* lds, int wid, int lane) const {
        const LAS float* S = (const LAS float*)(lds + 4096);
        const int col0 = u.pn * BM + wc * 32 + 4 * fq;
        const bool bad = st.run(acc, u, wr, wc, fr, fq, lds, wid, lane);
        const float qnan = __builtin_nanf("");
        f32x4 gv[2][2];
#pragma unroll
        for (int bj = 0; bj < 2; ++bj)
#pragma unroll
            for (int n = 0; n < 2; ++n) gv[bj][n] = *(const f32x4*)(gpost + col0 + bj * HALF + n * 16);
#pragma unroll
        for (int ai = 0; ai < 2; ++ai)
#pragma unroll
            for (int m = 0; m < 4; ++m) { const int r = ai * HALF + wr * 64 + m * 16 + fr; const float sr = S[r]; const size_t off = (size_t)(u.pm * BM + r) * D + col0;
#pragma unroll
                for (int bj = 0; bj < 2; ++bj)
#pragma unroll
                    for (int n = 0; n < 2; ++n) { const f32x4 bs = *(const f32x4*)(base + off + bj * HALF + n * 16); f32x4 o = bs + acc[ai][bj][m][n] * sr * gv[bj][n];
                        if (bad) o = (f32x4){qnan, qnan, qnan, qnan}; *(f32x4*)(out + off + bj * HALF + n * 16) = o; }
                if (m & 1) asm volatile("" ::: "memory"); }
    }
};
struct EpiRmsResRms {
    static constexpr bool PERM = false, AFTER_DRAIN = true;
    const float* base; float* out; bf16_t* xn; const float* gpost; RmsStats st1, st2;
    __device__ __forceinline__ void fused(f32x4 (&acc)[2][2][4][2], const Unit& u, int wr, int wc, int fr, int fq, LAS unsigned char* lds, int wid, int lane) const {
        const LAS float* S = (const LAS float*)(lds + 4096);
        const int col0 = u.pn * BM + wc * 32 + 4 * fq;
        bool bad = st1.run(acc, u, wr, wc, fr, fq, lds, wid, lane);
        const float qnan = __builtin_nanf("");
        {
        f32x4 gv[2][2];
#pragma unroll
        for (int bj = 0; bj < 2; ++bj)
#pragma unroll
            for (int n = 0; n < 2; ++n) gv[bj][n] = *(const f32x4*)(gpost + col0 + bj * HALF + n * 16);
#pragma unroll
        for (int ai = 0; ai < 2; ++ai)
#pragma unroll
            for (int m = 0; m < 4; ++m) { const int r = ai * HALF + wr * 64 + m * 16 + fr; const float sr = S[r]; const size_t off = (size_t)(u.pm * BM + r) * D + col0;
#pragma unroll
                for (int bj = 0; bj < 2; ++bj)
#pragma unroll
                    for (int n = 0; n < 2; ++n) { const f32x4 bs = *(const f32x4*)(base + off + bj * HALF + n * 16); acc[ai][bj][m][n] = bs + acc[ai][bj][m][n] * sr * gv[bj][n]; }
                asm volatile("" : "+v"(acc[ai][0][m][0]), "+v"(acc[ai][0][m][1]), "+v"(acc[ai][1][m][0]), "+v"(acc[ai][1][m][1]));
                if (m & 1) asm volatile("" ::: "memory"); }
        }
        const bool bad1 = bad;
        bad = st2.run(acc, u, wr, wc, fr, fq, lds, wid, lane) || bad;
#pragma unroll
        for (int ai = 0; ai < 2; ++ai)
#pragma unroll
            for (int m = 0; m < 4; ++m) { const int r = ai * HALF + wr * 64 + m * 16 + fr; const float sr = S[r]; const size_t off = (size_t)(u.pm * BM + r) * D + col0;
#pragma unroll
                for (int bj = 0; bj < 2; ++bj)
#pragma unroll
                    for (int n = 0; n < 2; ++n) { const f32x4 x1 = acc[ai][bj][m][n]; *(f32x4*)(out + off + bj * HALF + n * 16) = bad1 ? (f32x4){qnan, qnan, qnan, qnan} : x1;
                        const f32x4 o = x1 * sr; u32x2 w; w.x = cvt_pk_bf16(o[0], o[1]); w.y = cvt_pk_bf16(o[2], o[3]);
                        if (bad) { w.x = 0x7fc07fc0u; w.y = 0x7fc07fc0u; } *(u32x2*)(xn + off + bj * HALF + n * 16) = w; }
                asm volatile("" ::: "memory"); }
    }
};

template <class Epi, class Sched, bool ALIGN_EPI = false, bool SP2 = false>
__device__ __forceinline__ void gemm_phase(LAS unsigned char* lds, const Gemm g, const Sched& S, const Epi& E) {
    const int tid = threadIdx.x, wid = __builtin_amdgcn_readfirstlane(tid >> 6), lane = tid & 63, wr = wid >> 2, wc = wid & 3, fr = lane & 15, fq = lane >> 4;
    const int K = g.K, nt = K / BK;
    unsigned voffA[2], voffB[2];
#pragma unroll
    for (int i = 0; i < 2; ++i) { int R, C; stage_rc(tid * 16 + i * 8192, R, C); const int Rb = Epi::PERM ? ((R & ~31) + perm32(R & 31)) : R;
        voffA[i] = (unsigned)(R * K + C) * 2u; voffB[i] = (unsigned)(Rb * K + C) * 2u; }
    const size_t kstep = (size_t)(BK * 2);
    const size_t hstep = (size_t)HALF * K * 2;
    const size_t tstep = 2 * hstep;
    const unsigned ldsw = (unsigned)wid * 1024u;
    const int aoff = lds_byte(wr * 64 + fr, fq * 8), boff = lds_byte(wc * 32 + fr, fq * 8);
#define PG8_SA(b, h) (((b) * 2 + (h)) * HTB)
#define PG8_SB(b, h) ((4 + (b) * 2 + (h)) * HTB)
#define PG8_STAGE(bufoff, gbase, voff) do { _Pragma("unroll") for (int _i = 0; _i < 2; ++_i) \
        __builtin_amdgcn_global_load_lds((const unsigned*)((const char*)(gbase) + (voff)[_i]), (LAS unsigned*)(lds + (bufoff) + ldsw + _i * 8192), 16, 0, 0); } while (0)
#define PG8_LDA(dst, b, h) do { _Pragma("unroll") for (int m = 0; m < 4; ++m) _Pragma("unroll") for (int k = 0; k < 2; ++k) dst[m][k] = *(const LAS bf16x8*)(lds + PG8_SA(b, h) + aoff + m * 2048 + k * 1024); } while (0)
#define PG8_LDB(dst, b, h) do { _Pragma("unroll") for (int n = 0; n < 2; ++n) _Pragma("unroll") for (int k = 0; k < 2; ++k) dst[n][k] = *(const LAS bf16x8*)(lds + PG8_SB(b, h) + boff + n * 2048 + k * 1024); } while (0)
#define PG8_MMA(ai, bj, At, Bt) do { __builtin_amdgcn_s_setprio(1); _Pragma("unroll") for (int m = 0; m < 4; ++m) _Pragma("unroll") for (int n = 0; n < 2; ++n) _Pragma("unroll") for (int k = 0; k < 2; ++k) \
        acc[ai][bj][m][n] = __builtin_amdgcn_mfma_f32_16x16x32_bf16(Bt[n][k], At[m][k], acc[ai][bj][m][n], 0, 0, 0); __builtin_amdgcn_s_setprio(0); } while (0)
#define PG8_WAIT_V(n) asm volatile("s_waitcnt vmcnt(" #n ")" ::: "memory")
#define PG8_WAIT_L(n) asm volatile("s_waitcnt lgkmcnt(" #n ")" ::: "memory")
#define PG8_BAR __builtin_amdgcn_s_barrier()
#define PG8_SCHED __builtin_amdgcn_sched_barrier(0)
    Unit cur, nxt; int ui = 0;
    if (!S.next(0, cur)) return;
    f32x4 acc[2][2][4][2];
#pragma unroll
    for (int a = 0; a < 2; ++a)
#pragma unroll
        for (int b = 0; b < 2; ++b)
#pragma unroll
            for (int m = 0; m < 4; ++m)
#pragma unroll
                for (int n = 0; n < 2; ++n) acc[a][b][m][n] = (f32x4){0.f, 0.f, 0.f, 0.f};
    bf16x8 At[4][2], B0[2][2], B1[2][2];
    const char* cA = (const char*)g.A + (size_t)cur.pm * tstep; const char* cB = (const char*)g.Bt + (size_t)cur.pn * tstep;
    S.a_ready(cur);
    if constexpr (SP2) {
        PG8_STAGE(PG8_SB(0, 0), cB, voffB); PG8_STAGE(PG8_SB(0, 1), cB + hstep, voffB); PG8_STAGE(PG8_SA(0, 0), cA, voffA); PG8_STAGE(PG8_SA(0, 1), cA + hstep, voffA);
        if (wr == 1) PG8_BAR;
        PG8_WAIT_V(2); PG8_BAR;
        PG8_STAGE(PG8_SB(1, 0), cB + kstep, voffB); PG8_STAGE(PG8_SA(1, 0), cA + kstep, voffA); PG8_STAGE(PG8_SB(1, 1), cB + hstep + kstep, voffB);
        PG8_WAIT_V(6); PG8_BAR;
    } else {
        PG8_STAGE(PG8_SB(0, 0), cB, voffB); PG8_STAGE(PG8_SA(0, 0), cA, voffA); PG8_STAGE(PG8_SB(0, 1), cB + hstep, voffB); PG8_STAGE(PG8_SA(0, 1), cA + hstep, voffA);
        if (wr == 1) PG8_BAR;
        PG8_WAIT_V(4); PG8_BAR;
        PG8_STAGE(PG8_SB(1, 0), cB + kstep, voffB); PG8_STAGE(PG8_SA(1, 0), cA + kstep, voffA); PG8_STAGE(PG8_SB(1, 1), cB + hstep + kstep, voffB);
        PG8_WAIT_V(6); PG8_BAR;
    }
    for (;;) {
        const bool has_next = S.next(ui + 1, nxt);
        const char* nA = has_next ? (const char*)g.A + (size_t)nxt.pm * tstep : cA; const char* nB = has_next ? (const char*)g.Bt + (size_t)nxt.pn * tstep : cB;
        for (int t = 0; t < nt; t += 2) {
            const bool last = (t == nt - 2);
            const char* a1 = cA + (size_t)(t + 1) * kstep;
            const char* a2 = last ? nA : cA + (size_t)(t + 2) * kstep; const char* b2 = last ? nB : cB + (size_t)(t + 2) * kstep;
            const char* a3 = a2 + kstep; const char* b3 = b2 + kstep;
            if (last && has_next) S.a_ready(nxt);
            if constexpr (SP2) {
            PG8_LDB(B0, 0, 0); PG8_LDB(B1, 0, 1); PG8_SCHED; PG8_LDA(At, 0, 0); PG8_STAGE(PG8_SA(1, 1), a1 + hstep, voffA);
            PG8_WAIT_V(8); PG8_WAIT_L(0); PG8_BAR; PG8_MMA(0, 0, At, B0); PG8_MMA(0, 1, At, B1); PG8_BAR; PG8_SCHED;
            PG8_LDA(At, 0, 1); PG8_STAGE(PG8_SB(0, 0), b2, voffB); PG8_STAGE(PG8_SB(0, 1), b2 + hstep, voffB); PG8_STAGE(PG8_SA(0, 0), a2, voffA);
            PG8_WAIT_V(8); PG8_WAIT_L(0); PG8_BAR; PG8_MMA(1, 0, At, B0); PG8_MMA(1, 1, At, B1); PG8_BAR; PG8_SCHED;
            PG8_LDB(B0, 1, 0); PG8_LDB(B1, 1, 1); PG8_SCHED; PG8_LDA(At, 1, 0); PG8_STAGE(PG8_SA(0, 1), a2 + hstep, voffA);
            PG8_WAIT_V(8); PG8_WAIT_L(0); PG8_BAR; PG8_MMA(0, 0, At, B0); PG8_MMA(0, 1, At, B1); PG8_BAR; PG8_SCHED;
            PG8_LDA(At, 1, 1); PG8_STAGE(PG8_SB(1, 0), b3, voffB); PG8_STAGE(PG8_SB(1, 1), b3 + hstep, voffB); PG8_STAGE(PG8_SA(1, 0), a3, voffA);
            PG8_WAIT_V(8); PG8_WAIT_L(0); PG8_BAR; PG8_MMA(1, 0, At, B0); PG8_MMA(1, 1, At, B1); PG8_BAR; PG8_SCHED;
            } else {
            PG8_LDB(B0, 0, 0); PG8_SCHED; PG8_LDA(At, 0, 0); PG8_STAGE(PG8_SA(1, 1), a1 + hstep, voffA);
            PG8_WAIT_L(8); PG8_BAR; PG8_WAIT_L(0); PG8_MMA(0, 0, At, B0); PG8_BAR; PG8_SCHED;
            PG8_LDB(B1, 0, 1); PG8_STAGE(PG8_SB(0, 0), b2, voffB);
            PG8_BAR; PG8_WAIT_L(0); PG8_MMA(0, 1, At, B1); PG8_BAR;
            PG8_LDA(At, 0, 1); PG8_STAGE(PG8_SA(0, 0), a2, voffA);
            PG8_BAR; PG8_WAIT_L(0); PG8_MMA(1, 0, At, B0); PG8_BAR; PG8_SCHED;
            PG8_STAGE(PG8_SB(0, 1), b2 + hstep, voffB);
            PG8_WAIT_V(6); PG8_BAR; PG8_MMA(1, 1, At, B1); PG8_BAR;
            PG8_LDB(B0, 1, 0); PG8_SCHED; PG8_LDA(At, 1, 0); PG8_STAGE(PG8_SA(0, 1), a2 + hstep, voffA);
            PG8_WAIT_L(8); PG8_BAR; PG8_WAIT_L(0); PG8_MMA(0, 0, At, B0); PG8_BAR; PG8_SCHED;
            PG8_LDB(B1, 1, 1); PG8_STAGE(PG8_SB(1, 0), b3, voffB);
            PG8_BAR; PG8_WAIT_L(0); PG8_MMA(0, 1, At, B1); PG8_BAR;
            PG8_LDA(At, 1, 1); PG8_STAGE(PG8_SA(1, 0), a3, voffA);
            PG8_BAR; PG8_WAIT_L(0); PG8_MMA(1, 0, At, B0); PG8_BAR; PG8_SCHED;
            PG8_STAGE(PG8_SB(1, 1), b3 + hstep, voffB);
            PG8_WAIT_V(6); PG8_BAR; PG8_MMA(1, 1, At, B1); PG8_BAR;
            }
        }
        if constexpr (ALIGN_EPI) { if (wr == 0) PG8_BAR; }
        if constexpr (!Epi::AFTER_DRAIN) { E(acc, cur, wr, wc, fr, fq); S.done(cur); }
        if (!has_next) break;
#pragma unroll
        for (int a = 0; a < 2; ++a)
#pragma unroll
            for (int b = 0; b < 2; ++b)
#pragma unroll
                for (int m = 0; m < 4; ++m)
#pragma unroll
                    for (int n = 0; n < 2; ++n) acc[a][b][m][n] = (f32x4){0.f, 0.f, 0.f, 0.f};
        cur = nxt; cA = nA; cB = nB; ++ui;
        if constexpr (ALIGN_EPI) { if (wr == 1) PG8_BAR; }
    }
    PG8_WAIT_V(0);
    if constexpr (!ALIGN_EPI) { if (wr == 0) PG8_BAR; }
    PG8_BAR;
    if constexpr (Epi::AFTER_DRAIN) { E.fused(acc, cur, wr, wc, fr, fq, lds, wid, lane); S.done(cur); }
#undef PG8_SA
#undef PG8_SB
#undef PG8_STAGE
#undef PG8_LDA
#undef PG8_LDB
#undef PG8_MMA
#undef PG8_WAIT_V
#undef PG8_WAIT_L
#undef PG8_BAR
#undef PG8_SCHED
}
}

constexpr int NWAVES = 8;
constexpr int RING_OFF = 0, RING_BYTES = 131072;
constexpr int LDSCTL_OFF = RING_BYTES, MISC_OFF = LDSCTL_OFF + 320;
constexpr int LDS_BYTES = 147456;
typedef GAS unsigned gu32;
#define RLX_AGENT __ATOMIC_RELAXED, __HIP_MEMORY_SCOPE_AGENT
#define LDS_WAIT() asm volatile("s_waitcnt lgkmcnt(0)" ::: "memory")
#define VM_WAIT() asm volatile("s_waitcnt vmcnt(0)" ::: "memory")
#define XB_TMO      128
#define XB_XCNT(j)  (256  + 64 * (j))
#define XB_XSUB(j)  (1280 + 64 * (j))
#define XB_XGEN(j)  (2304 + 64 * (j))
#define XB_TOP      3328
#define XB_TOPGEN   3392
#define XCD_BAR_WORDS 3456
#define XB_SPIN_CAP (1u << 18)
__device__ __forceinline__ unsigned xb_ld(unsigned* p)              { return __hip_atomic_load(p, __ATOMIC_RELAXED, __HIP_MEMORY_SCOPE_AGENT); }
__device__ __forceinline__ unsigned xb_add(unsigned* p, unsigned v) { return __hip_atomic_fetch_add(p, v, __ATOMIC_RELAXED, __HIP_MEMORY_SCOPE_AGENT); }
__device__ __forceinline__ unsigned xb_xcc_id() { return (unsigned)__builtin_amdgcn_s_getreg((3 << 11) | 20) & 0xFu; }
#define XB_SPIN(cond, bar) do { unsigned _sp = 0; while (cond) { __builtin_amdgcn_s_sleep(1); \
    if ((++_sp & 255u) == 0u) { if (xb_ld(&(bar)[XB_TMO])) break; if (_sp > XB_SPIN_CAP) { atomicAdd(&(bar)[XB_TMO], 1u); break; } } } } while (0)
struct XcdBarrier { unsigned* bar; unsigned x; volatile LAS unsigned* st; };
__device__ __forceinline__ XcdBarrier xcd_barrier_post(unsigned* bar, volatile LAS unsigned* st) {
    XcdBarrier b; b.bar = bar; b.x = xb_xcc_id(); b.st = st;
    if (threadIdx.x == 0) (void)xb_add(&bar[XB_XCNT(b.x)], 1u);
    return b;
}
__device__ __forceinline__ void xcd_barrier_complete(unsigned* bar, unsigned x, unsigned& nloc, unsigned& nx) {
    const unsigned G = gridDim.x * gridDim.y * gridDim.z;
    unsigned sum, cnt, mine, sp = 0u;
    for (;;) {
        sum = 0u; cnt = 0u; mine = 0u;
#pragma unroll
        for (unsigned j = 0; j < 16; ++j) { const unsigned c = xb_ld(&bar[XB_XCNT(j)]); sum += c; cnt += (c > 0u) ? 1u : 0u; mine = (j == x) ? c : mine; }
        if (sum == G) break;
        __builtin_amdgcn_s_sleep(1);
        if ((++sp & 255u) == 0u) { if (xb_ld(&bar[XB_TMO])) break; if (sp > XB_SPIN_CAP) { atomicAdd(&bar[XB_TMO], 1u); break; } }
    }
    nloc = mine > 0u ? mine : 1u; nx = cnt > 0u ? cnt : 1u;
}
__device__ __forceinline__ void xcd_barrier(const XcdBarrier& b) {
    asm volatile("s_waitcnt vmcnt(0)" ::: "memory");
    __syncthreads();
    if (threadIdx.x == 0) {
        unsigned* bar = b.bar;
        __builtin_amdgcn_s_waitcnt(0);
        unsigned nloc = b.st[0], nx = b.st[1];
        if (nloc == 0u) { xcd_barrier_complete(bar, b.x, nloc, nx); b.st[0] = nloc; b.st[1] = nx; }
        const unsigned old = xb_add(&bar[XB_XSUB(b.x)], 1u);
        const unsigned gen = old / nloc;
        if (old + 1u == (gen + 1u) * nloc) {
            __builtin_amdgcn_fence(__ATOMIC_RELEASE, "agent");
            asm volatile("s_waitcnt vmcnt(0)" ::: "memory");
            const unsigned og = xb_add(&bar[XB_TOP], 1u);
            const unsigned tg = og / nx;
            if (og + 1u == (tg + 1u) * nx) xb_add(&bar[XB_TOPGEN], 1u);
            else XB_SPIN(xb_ld(&bar[XB_TOPGEN]) == tg, bar);
            __builtin_amdgcn_fence(__ATOMIC_ACQUIRE, "agent");
            xb_add(&bar[XB_XGEN(b.x)], 1u);
            asm volatile("s_waitcnt vmcnt(0)" ::: "memory");
        } else {
            XB_SPIN(xb_ld(&bar[XB_XGEN(b.x)]) == gen, bar);
            __builtin_amdgcn_fence(__ATOMIC_ACQUIRE, "agent");
            asm volatile("s_waitcnt vmcnt(0)" ::: "memory");
        }
    }
    __syncthreads();
}

struct Args { const float* in[23]; float* out; unsigned char* ws; int ph_lo, ph_hi; };
struct Frame {
    LAS unsigned char* lds; volatile LAS unsigned* MISC; gu32* ctl;
    int tid, lane, wave, vcu, G;
};
__device__ __forceinline__ float wave_sum(float v) {
#pragma unroll
    for (int o = 1; o < 64; o <<= 1) v += __shfl_xor(v, o);
    return v;
}
__device__ __forceinline__ void p0_transpose_item(const float* W, int K, int N, const float* g, float scale, bf16_t* WT, int k0, int n0, int dst_row0, LAS float* scr, int lane) {
#pragma unroll 8
    for (int i = 0; i < 32; ++i) { const int kk = 2 * i + (lane >> 5); float v = W[(size_t)(k0 + kk) * N + n0 + (lane & 31)] * scale; if (g) v *= g[k0 + kk]; scr[kk * 33 + (lane & 31)] = v; }
    LDS_WAIT(); asm volatile("" ::: "memory");
    const int c = lane & 7;
#pragma unroll
    for (int j = 0; j < 4; ++j) { const int n = (lane >> 3) + 8 * j; const LAS float* s = scr + (8 * c) * 33 + n;
        u32x4 o; o.x = pk2(s[0 * 33], s[1 * 33]); o.y = pk2(s[2 * 33], s[3 * 33]); o.z = pk2(s[4 * 33], s[5 * 33]); o.w = pk2(s[6 * 33], s[7 * 33]);
        *(GAS u32x4*)(WT + (size_t)(dst_row0 + n) * K + k0 + 8 * c) = o; }
    LDS_WAIT(); asm volatile("" ::: "memory");
}
__device__ __forceinline__ int w1_dst_row(int n) {
    if (n < 512) return n;
    const int part = (n - 512) >> 9, ch = (n - 512) & 511, t = ch >> 7, i = ch & 127;
    return 512 + ((part >> 1) * 4 + t) * 256 + (part & 1) * 128 + i;
}
__device__ __forceinline__ void p0_prologue(Frame& F, const Args& a, unsigned char* ws) {
    LAS float* scr = (LAS float*)(F.lds + RING_OFF + F.wave * 16384);
    const int gw = F.vcu * NWAVES + F.wave, NGW = F.G * NWAVES;
    constexpr int I_SQ = (D / 64) * (D / 32), I_1 = (D / 64) * (NU / 32), I_G = (D / 64) * (FF / 32), I_D = (FF / 64) * (D / 32);
    constexpr int NITEMS = I_1 + 5 * I_SQ + 2 * I_G + I_D;
    for (int it = gw; it < NITEMS; it += NGW) {
        int r = it;
        if (r < I_1) { const int nb = NU / 32, k0 = 64 * (r / nb), n0 = 32 * (r % nb); p0_transpose_item(a.in[3], D, NU, a.in[2], 1.f, (bf16_t*)(ws + WS_W1), k0, n0, w1_dst_row(n0), scr, F.lane); continue; } r -= I_1;
        if (r < 5 * I_SQ) { const int w = r / I_SQ, q = r % I_SQ, nb = D / 32, k0 = 64 * (q / nb), n0 = 32 * (q % nb);
            const float* W = w == 0 ? a.in[9] : w == 1 ? a.in[13] : w == 2 ? a.in[14] : w == 3 ? a.in[15] : a.in[16];
            const float* g = w == 1 ? a.in[11] : nullptr; const float sc = w == 1 ? QSCALE : 1.f;
            bf16_t* dst = (bf16_t*)(ws + (w == 0 ? WS_WOUT : w == 1 ? WS_WQ : w == 2 ? WS_WK : w == 3 ? WS_WV : WS_WO));
            p0_transpose_item(W, D, D, g, sc, dst, k0, n0, n0, scr, F.lane); continue; } r -= 5 * I_SQ;
        if (r < 2 * I_G) { const int w = r / I_G, q = r % I_G, nb = FF / 32, k0 = 64 * (q / nb), n0 = 32 * (q % nb);
            p0_transpose_item(w == 0 ? a.in[19] : a.in[20], D, FF, a.in[18], 1.f, (bf16_t*)(ws + WS_WGU), k0, n0, 256 * (n0 >> 7) + 128 * w + (n0 & 127), scr, F.lane); continue; } r -= 2 * I_G;
        { const int nb = D / 32, k0 = 64 * (r / nb), n0 = 32 * (r % nb); p0_transpose_item(a.in[21], FF, D, nullptr, 1.f, (bf16_t*)(ws + WS_WD), k0, n0, n0, scr, F.lane); }
    }
    for (int m = gw; m < M + NMEM; m += NGW) {
        const bool ismem = m >= M; const int row = ismem ? m - M : m;
        const GAS f32x4* xr = (const GAS f32x4*)((ismem ? a.in[1] : a.in[0]) + (size_t)row * D) + F.lane;
        f32x4 v[4]; float s = 0.f;
#pragma unroll
        for (int j = 0; j < 4; ++j) { v[j] = xr[64 * j]; s += (v[j].x * v[j].x + v[j].y * v[j].y) + (v[j].z * v[j].z + v[j].w * v[j].w); }
        const float rstd = 1.f / sqrtf(wave_sum(s) * (1.f / D) + RMS_EPS);
        if (ismem) {
            int pos = 0;
#pragma unroll 1
            for (int q = (row & ~15); q < (row & ~15) + 16; ++q) if (vkey_of_pos(q) == row) pos = q;
            GAS unsigned long long* o1 = (GAS unsigned long long*)((bf16_t*)(ws + WS_MEMN) + (size_t)row * D) + F.lane;
            GAS unsigned long long* o2 = (GAS unsigned long long*)((bf16_t*)(ws + WS_MEMNP) + (size_t)pos * D) + F.lane;
#pragma unroll
            for (int j = 0; j < 4; ++j) { const f32x4 gg = *((const GAS f32x4*)a.in[12] + F.lane + 64 * j);
                const unsigned long long w = (unsigned long long)pk2(v[j].x * rstd * gg.x, v[j].y * rstd * gg.y) | ((unsigned long long)pk2(v[j].z * rstd * gg.z, v[j].w * rstd * gg.w) << 32);
                o1[64 * j] = w; o2[64 * j] = w; }
        } else {
            GAS unsigned long long* o8 = (GAS unsigned long long*)((bf16_t*)(ws + WS_XN) + (size_t)row * D) + F.lane;
#pragma unroll
            for (int j = 0; j < 4; ++j) o8[64 * j] = (unsigned long long)pk2(v[j].x * rstd, v[j].y * rstd) | ((unsigned long long)pk2(v[j].z * rstd, v[j].w * rstd) << 32);
        }
    }
}

template <int N> __device__ __forceinline__ void tr_step(float (&v)[64], int lane) {
    constexpr int H = N / 2; const bool up = (lane & H) != 0;
#pragma unroll
    for (int i = 0; i < H; ++i) { const float send = up ? v[i] : v[i + H]; const float keep = up ? v[i + H] : v[i]; v[i] = keep + __shfl_xor(send, H); }
}
__device__ __forceinline__ void conv_phase(Frame& F, const Args& a, unsigned char* ws) {
    const bf16_t* U = (const bf16_t*)(ws + WS_U); bf16_t* Y = (bf16_t*)(ws + WS_Y);
    const float* wa = a.in[4]; const float* wb = a.in[5]; const float* bb = a.in[6]; const float* lg = a.in[7]; const float* lb = a.in[8];
    const int tid = F.tid, lane = F.lane, w = F.wave;
    LAS unsigned char* lds = F.lds;
    LAS float* part = (LAS float*)(lds + 98304);
    LAS float* fin = (LAS float*)(lds + 98304 + 2048);
    for (int tile = F.vcu; tile < M / 64; tile += F.G) {
        const int t0 = tile * 64;
#pragma unroll
        for (int it = 0; it < 12; ++it) { const int idx = tid + 512 * it;
            if (idx < 94 * 64) { const int row = idx >> 6, pc = idx & 63, tok = t0 - 30 + row; u32x4 v = {0u, 0u, 0u, 0u};
                if (tok >= 0) v = *(const u32x4*)(U + (size_t)tok * UW + 1024 + 8 * pc);
                *(LAS u32x4*)(lds + row * 1024 + pc * 16) = v; } }
        {
            const int tb = t0 + 8 * w, c8 = 8 * lane;
            float w0[8], w1[8], w2[8];
#pragma unroll
            for (int e = 0; e < 8; ++e) { w0[e] = wa[c8 + e]; w1[e] = wa[DA + c8 + e]; w2[e] = wa[2 * DA + c8 + e]; }
            u32x4 cv[10];
#pragma unroll
            for (int i = 0; i < 10; ++i) { const int tok = tb - 2 + i; cv[i] = (u32x4){0u, 0u, 0u, 0u}; if (tok >= 0) cv[i] = *(const u32x4*)(U + (size_t)tok * UW + 512 + c8); }
#pragma unroll
            for (int i = 0; i < 8; ++i) { const u32x4 bv = *(const u32x4*)(U + (size_t)(tb + i) * UW + c8); float y[8];
#pragma unroll
                for (int e2 = 0; e2 < 4; ++e2) {
                    const float c0l = bflo(cv[i][e2]), c0h = bfhi(cv[i][e2]), c1l = bflo(cv[i + 1][e2]), c1h = bfhi(cv[i + 1][e2]), c2l = bflo(cv[i + 2][e2]), c2h = bfhi(cv[i + 2][e2]);
                    y[2 * e2] = bflo(bv[e2]) * (w0[2 * e2] * c0l + w1[2 * e2] * c1l + w2[2 * e2] * c2l);
                    y[2 * e2 + 1] = bfhi(bv[e2]) * (w0[2 * e2 + 1] * c0h + w1[2 * e2 + 1] * c1h + w2[2 * e2 + 1] * c2h); }
                u32x4 o; o.x = pk2(y[0], y[1]); o.y = pk2(y[2], y[3]); o.z = pk2(y[4], y[5]); o.w = pk2(y[6], y[7]);
                *(u32x4*)(Y + (size_t)(tb + i) * D + c8) = o; }
        }
        __syncthreads();
        const int cgrp = w & 3, tgrp = w >> 2, c0 = 128 * cgrp + 2 * lane;
        float wk0[31], wk1[31];
#pragma unroll
        for (int k = 0; k < 31; ++k) { const f32x2 t = *(const f32x2*)(wb + k * DA + c0); wk0[k] = t.x; wk1[k] = t.y; }
        const f32x2 bias = *(const f32x2*)(bb + c0);
        float o0[32], o1[32];
#pragma unroll
        for (int g = 0; g < 4; ++g) {
            float a0[8], a1[8];
#pragma unroll
            for (int tt = 0; tt < 8; ++tt) { a0[tt] = bias.x; a1[tt] = bias.y; }
#pragma unroll
            for (int rr = 0; rr < 38; ++rr) {
                const unsigned zz = *(const LAS unsigned*)(lds + (32 * tgrp + 8 * g + rr) * 1024 + c0 * 2); const float z0 = bflo(zz), z1 = bfhi(zz);
#pragma unroll
                for (int tt = 0; tt < 8; ++tt) { const int k = rr - tt; if (k >= 0 && k <= 30) { a0[tt] += wk0[k] * z0; a1[tt] += wk1[k] * z1; } }
            }
#pragma unroll
            for (int tt = 0; tt < 8; ++tt) { o0[8 * g + tt] = a0[tt]; o1[8 * g + tt] = a1[tt]; }
        }
        {
            float v[64];
#pragma unroll
            for (int i = 0; i < 32; ++i) { v[i] = o0[i] + o1[i]; v[32 + i] = o0[i] * o0[i] + o1[i] * o1[i]; }
            tr_step<64>(v, lane); tr_step<32>(v, lane); tr_step<16>(v, lane); tr_step<8>(v, lane); tr_step<4>(v, lane); tr_step<2>(v, lane);
            part[w * 64 + lane] = v[0];
        }
        __syncthreads();
        if (tid < 128) { const int tok = tid & 63, which = tid >> 6, tg = tok >> 5, ti = tok & 31; float s = 0.f;
#pragma unroll
            for (int cg = 0; cg < 4; ++cg) s += part[(tg * 4 + cg) * 64 + which * 32 + ti];
            fin[tok * 2 + which] = s; }
        __syncthreads();
        const f32x2 gam = *(const f32x2*)(lg + c0), bet = *(const f32x2*)(lb + c0);
#pragma unroll
        for (int i = 0; i < 32; ++i) { const int tok = 32 * tgrp + i; const f32x2 st = *(const LAS f32x2*)(fin + tok * 2);
            const float mean = st.x * (1.f / DA); const float var = fmaxf(st.y * (1.f / DA) - mean * mean, 0.f); const float rstd = 1.f / sqrtf(var + LN_EPS);
            const float y0 = (o0[i] - mean) * rstd * gam.x + bet.x, y1 = (o1[i] - mean) * rstd * gam.y + bet.y;
            *(unsigned*)(Y + (size_t)(t0 + tok) * D + 512 + c0) = pk2(y0 * sigmoidf_(y0), y1 * sigmoidf_(y1)); }
        __syncthreads();
    }
}

__device__ __forceinline__ void attn_unit(LAS unsigned char* lds, const bf16_t* Q, const bf16_t* Km, const bf16_t* Vt, bf16_t* O, int pm, int h, int tid) {
    const int lane = tid & 63, r32 = lane & 31, hi = lane >> 5; const int wid = __builtin_amdgcn_readfirstlane(tid >> 6);
    const size_t qrow = (size_t)pm * 256 + wid * 32 + r32;
    bf16x8 qr[16];
    { const bf16_t* qp = Q + qrow * D + h * HD + hi * 8;
#pragma unroll
      for (int ks = 0; ks < 16; ++ks) qr[ks] = *(const bf16x8*)(qp + 16 * ks); }
    f32x16 p[8];
#pragma unroll
    for (int kt = 0; kt < 8; ++kt) p[kt] = (f32x16){};
    u32x4 st[4];
    const bf16_t* kbase = Km + h * HD; const bf16_t* vbase = Vt + (size_t)h * HD * NMEM;
#define AT_LOADK(c) do { _Pragma("unroll") for (int j = 0; j < 4; ++j) { const int i_ = tid + 512 * j, row_ = i_ >> 3, pc_ = i_ & 7; st[j] = *(const u32x4*)(kbase + (size_t)row_ * D + 64 * (c) + 8 * pc_); } } while (0)
#define AT_WRITEK(b) do { _Pragma("unroll") for (int j = 0; j < 4; ++j) { const int i_ = tid + 512 * j, row_ = i_ >> 3, pc_ = i_ & 7; *(LAS u32x4*)(lds + (b) * 32768 + row_ * 128 + ((pc_ ^ (row_ & 7)) << 4)) = st[j]; } } while (0)
#define AT_LOADV(c) do { _Pragma("unroll") for (int j = 0; j < 4; ++j) { const int i_ = tid + 512 * j, row_ = i_ >> 5, pc_ = i_ & 31; st[j] = *(const u32x4*)(vbase + (size_t)(64 * (c) + row_) * NMEM + 8 * pc_); } } while (0)
#define AT_WRITEV(b) do { _Pragma("unroll") for (int j = 0; j < 4; ++j) { const int i_ = tid + 512 * j, row_ = i_ >> 5, pc_ = i_ & 31; *(LAS u32x4*)(lds + (b) * 32768 + row_ * 512 + ((pc_ ^ (row_ & 15)) << 4)) = st[j]; } } while (0)
    AT_LOADK(0); AT_WRITEK(0);
#pragma unroll
    for (int c = 0; c < 4; ++c) {
        if (c < 3) AT_LOADK(c + 1); else AT_LOADV(0);
        __syncthreads();
        const LAS unsigned char* kb = lds + (c & 1) * 32768 + r32 * 128;
#pragma unroll
        for (int kt = 0; kt < 8; ++kt)
#pragma unroll
            for (int ks = 0; ks < 4; ++ks) { const bf16x8 af = *(const LAS bf16x8*)(kb + kt * 4096 + (((2 * ks + hi) ^ (r32 & 7)) << 4));
                p[kt] = __builtin_amdgcn_mfma_f32_32x32x16_bf16(af, qr[4 * c + ks], p[kt], 0, 0, 0); }
        if (c < 3) AT_WRITEK((c + 1) & 1); else AT_WRITEV(0);
    }
    float mx = p[0][0];
#pragma unroll
    for (int kt = 0; kt < 8; ++kt)
#pragma unroll
        for (int r = 0; r < 16; ++r) mx = fmaxf(mx, p[kt][r]);
    mx = fmaxf(mx, __shfl_xor(mx, 32));
    float l = 0.f;
#pragma unroll
    for (int kt = 0; kt < 8; ++kt)
#pragma unroll
        for (int r = 0; r < 16; ++r) { const float e = __builtin_amdgcn_exp2f(p[kt][r] - mx); p[kt][r] = e; l += e; }
    l += __shfl_xor(l, 32);
    bf16x8 pb[8][2];
#pragma unroll
    for (int kt = 0; kt < 8; ++kt)
#pragma unroll
        for (int s = 0; s < 2; ++s) { u32x4 wv; wv.x = pg8::cvt_pk_bf16(p[kt][8 * s + 0], p[kt][8 * s + 1]); wv.y = pg8::cvt_pk_bf16(p[kt][8 * s + 2], p[kt][8 * s + 3]);
            wv.z = pg8::cvt_pk_bf16(p[kt][8 * s + 4], p[kt][8 * s + 5]); wv.w = pg8::cvt_pk_bf16(p[kt][8 * s + 6], p[kt][8 * s + 7]); pb[kt][s] = __builtin_bit_cast(bf16x8, wv); }
    f32x16 o[8];
#pragma unroll
    for (int dt = 0; dt < 8; ++dt) o[dt] = (f32x16){};
#pragma unroll
    for (int c = 0; c < 4; ++c) {
        if (c < 3) AT_LOADV(c + 1);
        __syncthreads();
        const LAS unsigned char* vb = lds + (c & 1) * 32768 + r32 * 512;
#pragma unroll
        for (int dl = 0; dl < 2; ++dl)
#pragma unroll
            for (int kt = 0; kt < 8; ++kt)
#pragma unroll
                for (int s = 0; s < 2; ++s) { const bf16x8 af = *(const LAS bf16x8*)(vb + dl * 16384 + (((4 * kt + 2 * s + hi) ^ (r32 & 15)) << 4));
                    o[2 * c + dl] = __builtin_amdgcn_mfma_f32_32x32x16_bf16(af, pb[kt][s], o[2 * c + dl], 0, 0, 0); }
        if (c < 3) AT_WRITEV((c + 1) & 1);
    }
    const float inv = 1.0f / l;
    bf16_t* op = O + qrow * D + h * HD + 4 * hi;
#pragma unroll
    for (int dt = 0; dt < 8; ++dt)
#pragma unroll
        for (int g = 0; g < 4; ++g) { u32x2 wv; wv.x = pg8::cvt_pk_bf16(o[dt][4 * g + 0] * inv, o[dt][4 * g + 1] * inv); wv.y = pg8::cvt_pk_bf16(o[dt][4 * g + 2] * inv, o[dt][4 * g + 3] * inv);
            *(u32x2*)(op + 32 * dt + 8 * g) = wv; }
    __syncthreads();
#undef AT_LOADK
#undef AT_WRITEK
#undef AT_LOADV
#undef AT_WRITEV
}

__global__ void __launch_bounds__(NWAVES * 64, 2) mk_fwd(Args args) {
    extern __shared__ __attribute__((aligned(16))) unsigned char lds[];
    Frame F;
    F.lds = (LAS unsigned char*)lds;
    F.MISC = (volatile LAS unsigned*)(F.lds + MISC_OFF);
    F.tid = threadIdx.x; F.lane = F.tid & 63; F.wave = __builtin_amdgcn_readfirstlane(F.tid >> 6);
    F.G = gridDim.x; { const int bx = blockIdx.x; F.vcu = (F.G % 8 == 0) ? (bx % 8) * (F.G / 8) + bx / 8 : bx; }
    unsigned char* ws = args.ws;
    F.ctl = (gu32*)(ws + WS_CTL);
    for (int u = F.tid; u < (LDS_BYTES - LDSCTL_OFF) / 4; u += NWAVES * 64) ((LAS unsigned*)(F.lds + LDSCTL_OFF))[u] = 0u;
    __syncthreads();
    const int lo = args.ph_lo, hi = args.ph_hi;
    XcdBarrier bar; bar.bar = (unsigned*)(F.ctl + CW_BAR) + lo * XCD_BAR_WORDS; bar.x = 0; bar.st = nullptr;
    if (hi - lo > 1) bar = xcd_barrier_post((unsigned*)(F.ctl + CW_BAR) + lo * XCD_BAR_WORDS, F.MISC + 8);
#define IN(k) ((((OPT_MASK) >> (k)) & 1) && lo <= (k) && (k) < hi)
#define SEAM(k) do { if (IN(k) && IN((k) + 1)) xcd_barrier(bar); } while (0)
    bf16_t* XN = (bf16_t*)(ws + WS_XN); unsigned* tmo = (unsigned*)(F.ctl + CW_TMO);
#define SEAMW(b) ((unsigned*)(F.ctl + CW_SEAM + (b) * SEAM_BANK))
#define XSLOT(b) ((unsigned*)(ws + WS_X + (b) * XSLOT_BYTES))

    if (IN(0)) { p0_prologue(F, args, ws); } SEAM(0);

    if (IN(1)) {
        { pg8::Gemm g{XN, (const bf16_t*)(ws + WS_W1), M, NU, D}; pg8::StaticOrder S; S.init(M, NU, F.G, (int)blockIdx.x);
          pg8::EpiU E{(bf16_t*)(ws + WS_U)};
          pg8::gemm_phase<pg8::EpiU, pg8::StaticOrder, true, true>(F.lds + RING_OFF, g, S, E); }
        { pg8::Gemm g{(const bf16_t*)(ws + WS_MEMN), (const bf16_t*)(ws + WS_WK), 1280, 1280, D}; pg8::KVOrder S{(int)blockIdx.x - 128};
          pg8::EpiKV E{(bf16_t*)(ws + WS_KM), (bf16_t*)(ws + WS_VT)};
          pg8::gemm_phase<pg8::EpiKV, pg8::KVOrder, false, true>(F.lds + RING_OFF, g, S, E); }
    } SEAM(1);

    if (IN(2)) { conv_phase(F, args, ws); } SEAM(2);

    if (IN(3)) {
        pg8::Gemm g{(const bf16_t*)(ws + WS_Y), (const bf16_t*)(ws + WS_WOUT), M, D, D}; pg8::StaticOrder S; S.init(M, D, F.G, (int)blockIdx.x);
        pg8::RmsStats s1{XSLOT(0), SEAMW(0), tmo, 0x710u}, s2{XSLOT(1), SEAMW(1), tmo, 0x720u};
        pg8::EpiRmsResRms E{args.in[0], args.out, XN, args.in[10], s1, s2};
        pg8::gemm_phase<pg8::EpiRmsResRms, pg8::StaticOrder, false, true>(F.lds + RING_OFF, g, S, E);
    } SEAM(3);

    if (IN(4)) {
        pg8::Gemm g{XN, (const bf16_t*)(ws + WS_WQ), M, D, D}; pg8::StaticOrder S; S.init(M, D, F.G, (int)blockIdx.x);
        pg8::EpiBf16P E{(bf16_t*)(ws + WS_QO), D};
        pg8::gemm_phase<pg8::EpiBf16P, pg8::StaticOrder, false, true>(F.lds + RING_OFF, g, S, E);
    } SEAM(4);

    if (IN(5)) {
        for (int u = F.vcu; u < (M / 256) * NH; u += F.G)
            attn_unit(F.lds + RING_OFF, (const bf16_t*)(ws + WS_QO), (const bf16_t*)(ws + WS_KM), (const bf16_t*)(ws + WS_VT), (bf16_t*)(ws + WS_QO), u >> 2, u & 3, F.tid);
    } SEAM(5);

    if (IN(6)) {
        pg8::Gemm g{(const bf16_t*)(ws + WS_QO), (const bf16_t*)(ws + WS_WO), M, D, D}; pg8::StaticOrder S; S.init(M, D, F.G, (int)blockIdx.x);
        pg8::RmsStats s1{XSLOT(2), SEAMW(2), tmo, 0x730u}, s2{XSLOT(3), SEAMW(3), tmo, 0x740u};
        pg8::EpiRmsResRms E{args.out, args.out, XN, args.in[17], s1, s2};
        pg8::gemm_phase<pg8::EpiRmsResRms, pg8::StaticOrder, false, true>(F.lds + RING_OFF, g, S, E);
    } SEAM(6);

    if (IN(7)) {
        pg8::Gemm g{XN, (const bf16_t*)(ws + WS_WGU), M, NGU, D}; pg8::StaticOrder S; S.init(M, NGU, F.G, (int)blockIdx.x);
        pg8::EpiSwiGLU E{(bf16_t*)(ws + WS_ACT)};
        pg8::gemm_phase<pg8::EpiSwiGLU, pg8::StaticOrder, true, true>(F.lds + RING_OFF, g, S, E);
    } SEAM(7);

    if (IN(8)) {
        pg8::Gemm g{(const bf16_t*)(ws + WS_ACT), (const bf16_t*)(ws + WS_WD), M, D, FF}; pg8::StaticOrder S; S.init(M, D, F.G, (int)blockIdx.x);
        pg8::RmsStats s1{XSLOT(4), SEAMW(4), tmo, 0x750u};
        pg8::EpiRmsRes E{args.out, args.out, args.in[22], s1};
        pg8::gemm_phase<pg8::EpiRmsRes, pg8::StaticOrder, false, true>(F.lds + RING_OFF, g, S, E);
    }
#undef IN
#undef SEAM
}

template <class Epi> static void launch_ngemm(const bf16_t* A, const bf16_t* Bt, int Mr, int Ncols, int K, Epi e, hipStream_t s) {
    const int waves = (Mr / 32) * (Epi::NT == 1 ? Ncols / 32 : Ncols / 64);
    hipLaunchKernelGGL(nk_gemm<Epi>, dim3((waves + 3) / 4), dim3(256), 0, s, A, Bt, Mr, Ncols, K, e);
}
static void naive_phase(int p, const float* const* in, float* out, unsigned char* ws, hipStream_t s) {
    bf16_t* XN = (bf16_t*)(ws + WS_XN); float* C = (float*)(ws + WS_C);
    auto prep = [&](const float* W, const float* W2, const float* g, float sc, size_t off, int K, int Nsrc, int Ndst, int mode) {
        const size_t n = (size_t)Ndst * K; hipLaunchKernelGGL(nk_prep_w, dim3((unsigned)((n + 255) / 256)), dim3(256), 0, s, W, W2, g, sc, (bf16_t*)(ws + off), K, Nsrc, Ndst, mode); };
    switch (p) {
    case 0:
        prep(in[3], nullptr, in[2], 1.f, WS_W1, D, NU, NU, 1); prep(in[9], nullptr, nullptr, 1.f, WS_WOUT, D, D, D, 0); prep(in[13], nullptr, in[11], QSCALE, WS_WQ, D, D, D, 0);
        prep(in[14], nullptr, nullptr, 1.f, WS_WK, D, D, D, 0); prep(in[15], nullptr, nullptr, 1.f, WS_WV, D, D, D, 0); prep(in[16], nullptr, nullptr, 1.f, WS_WO, D, D, D, 0);
        prep(in[19], in[20], in[18], 1.f, WS_WGU, D, FF, NGU, 2); prep(in[21], nullptr, nullptr, 1.f, WS_WD, FF, D, D, 0);
        hipLaunchKernelGGL(nk_rmsrow, dim3(M), dim3(256), 0, s, in[0], (const float*)nullptr, XN, (bf16_t*)nullptr, 0);
        hipLaunchKernelGGL(nk_rmsrow, dim3(NMEM), dim3(256), 0, s, in[1], in[12], (bf16_t*)(ws + WS_MEMN), (bf16_t*)(ws + WS_MEMNP), 1);
        break;
    case 1:
        launch_ngemm(XN, (const bf16_t*)(ws + WS_W1), M, 512, D, NEpiBf16{(bf16_t*)(ws + WS_U), UW, 0}, s);
        launch_ngemm(XN, (const bf16_t*)(ws + WS_W1) + (size_t)512 * D, M, 2048, D, NEpiPair{(bf16_t*)(ws + WS_U), UW, 512, 4, 1}, s);
        launch_ngemm((const bf16_t*)(ws + WS_MEMN), (const bf16_t*)(ws + WS_WK), NMEM, D, D, NEpiBf16{(bf16_t*)(ws + WS_KM), D, 0}, s);
        launch_ngemm((const bf16_t*)(ws + WS_WV), (const bf16_t*)(ws + WS_MEMNP), D, NMEM, D, NEpiBf16{(bf16_t*)(ws + WS_VT), NMEM, 0}, s);
        break;
    case 2: hipLaunchKernelGGL(nk_conv, dim3(M), dim3(512), 0, s, (const bf16_t*)(ws + WS_U), in[4], in[5], in[6], in[7], in[8], (bf16_t*)(ws + WS_Y)); break;
    case 3:
        launch_ngemm((const bf16_t*)(ws + WS_Y), (const bf16_t*)(ws + WS_WOUT), M, D, D, NEpiF32{C, D, 0}, s);
        hipLaunchKernelGGL(nk_rownorm, dim3(M), dim3(256), 0, s, (const float*)C, in[0], in[10], out, XN); break;
    case 4: launch_ngemm(XN, (const bf16_t*)(ws + WS_WQ), M, D, D, NEpiBf16{(bf16_t*)(ws + WS_QO), D, 0}, s); break;
    case 5: hipLaunchKernelGGL(nk_attn, dim3(M * NH), dim3(256), 0, s, (const bf16_t*)(ws + WS_QO), (const bf16_t*)(ws + WS_KM), (const bf16_t*)(ws + WS_VT), (bf16_t*)(ws + WS_QO)); break;
    case 6:
        launch_ngemm((const bf16_t*)(ws + WS_QO), (const bf16_t*)(ws + WS_WO), M, D, D, NEpiF32{C, D, 0}, s);
        hipLaunchKernelGGL(nk_rownorm, dim3(M), dim3(256), 0, s, (const float*)C, (const float*)out, in[17], out, XN); break;
    case 7: launch_ngemm(XN, (const bf16_t*)(ws + WS_WGU), M, NGU, D, NEpiPair{(bf16_t*)(ws + WS_ACT), FF, 0, 0, 2}, s); break;
    case 8:
        launch_ngemm((const bf16_t*)(ws + WS_ACT), (const bf16_t*)(ws + WS_WD), M, D, FF, NEpiF32{C, D, 0}, s);
        hipLaunchKernelGGL(nk_rownorm, dim3(M), dim3(256), 0, s, (const float*)C, (const float*)out, in[22], out, (bf16_t*)nullptr); break;
    }
}
extern "C" void kernel_launch(void* const* d_in, const int* in_sizes, int n_in, void* d_out, int out_size, void* d_ws, size_t ws_size, hipStream_t stream) {
    static int grid = 0;
    if (grid == 0) {
        if (n_in != 23 || in_sizes[0] != M * D || out_size != M * D || ws_size < WS_END) { fprintf(stderr, "kernel_launch: unexpected shapes (n_in %d, in0 %d, out %d, ws %zu)\n", n_in, n_in > 0 ? in_sizes[0] : -1, out_size, ws_size); grid = -1; return; }
        int dev = 0, cus = 0, per_cu = 0;
        if (hipGetDevice(&dev) != hipSuccess || hipDeviceGetAttribute(&cus, hipDeviceAttributeMultiprocessorCount, dev) != hipSuccess) { grid = -1; return; }
        if (hipFuncSetAttribute((const void*)mk_fwd, hipFuncAttributeMaxDynamicSharedMemorySize, LDS_BYTES) != hipSuccess) { fprintf(stderr, "kernel_launch: hipFuncSetAttribute failed\n"); grid = -1; return; }
        if (hipOccupancyMaxActiveBlocksPerMultiprocessor(&per_cu, (const void*)mk_fwd, NWAVES * 64, LDS_BYTES) != hipSuccess || per_cu < 1)
            fprintf(stderr, "kernel_launch: note: occupancy query reports %d workgroups per CU\n", per_cu);
        (void)hipGetLastError();
        grid = cus;
        if (grid != 256) fprintf(stderr, "kernel_launch: %d CUs; the fused epilogues need exactly 256 workgroups\n", grid);
    }
    if (grid < 0) return;
    (void)hipMemsetAsync((char*)d_ws + WS_CTL, 0, CTL_ZERO_BYTES, stream);
    Args a{};
    for (int i = 0; i < 23; ++i) a.in[i] = (const float*)d_in[i];
    a.out = (float*)d_out; a.ws = (unsigned char*)d_ws;
    int p = 0;
    while (p < 9) {
        if (!((OPT_MASK >> p) & 1)) { naive_phase(p, a.in, a.out, a.ws, stream); ++p; continue; }
        int q = p + 1;
        if (ONE_LAUNCH) while (q < 9 && ((OPT_MASK >> q) & 1)) ++q;
        a.ph_lo = p; a.ph_hi = q;
        hipLaunchKernelGGL(mk_fwd, dim3(grid), dim3(NWAVES * 64), LDS_BYTES, stream, a);
        p = q;
    }
}
```
